# Optimizing an MI355X kernel written in HIP

```python
import jax, jax.numpy as jnp
from jax import lax
import numpy as np

D_MODEL = 1024
BATCH = 8
SEQ = 2048
DEPTH = 2

CHUNK = 64
N_MIXERS = 2
N_LAYERS_A = (DEPTH + 1) // 2
N_LAYERS_B = DEPTH // 2
RMS_EPS = 1e-6

GLA_HEADS = 4
KEY_DIM = D_MODEL // 2
VALUE_DIM = D_MODEL
HEAD_K = KEY_DIM // GLA_HEADS
HEAD_V = VALUE_DIM // GLA_HEADS
GATE_RANK = 16
GATE_NORMALIZER = 16.0
PROJ_A = 2 * KEY_DIM + 2 * VALUE_DIM + GATE_RANK
SPLITS_A = (KEY_DIM, 2 * KEY_DIM, 2 * KEY_DIM + VALUE_DIM, 2 * KEY_DIM + 2 * VALUE_DIM)

CONV_DIM = D_MODEL
CONV_WIDTH = 3

D_FF = 2816
FFN_CONV_WIDTH = 3

kernel_name = 'hybrid_gla_shortconv_convffn_trunk'


def _rmsnorm(x, g):
    xf = x.astype(jnp.float32)
    y = xf * lax.rsqrt(jnp.mean(xf * xf, axis=-1, keepdims=True) + RMS_EPS)
    return (y * g.astype(jnp.float32)).astype(x.dtype)


def _causal_dwconv(z, w):
    width, ch = w.shape
    return lax.conv_general_dilated(
        z, w[:, None, :].astype(z.dtype), window_strides=(1,),
        padding=[(width - 1, 0)], dimension_numbers=('NWC', 'WIO', 'NWC'),
        feature_group_count=ch)


def _gla_mixer(x, w_in, w_gate_up, b_gate, gn, w_out):
    bsz, seq, _ = x.shape
    n_chunks = seq // CHUNK
    proj = x @ w_in
    q, k, v, r, gl = jnp.split(proj, SPLITS_A, axis=-1)
    log_a = jax.nn.log_sigmoid((gl @ w_gate_up + b_gate).astype(jnp.float32)) / GATE_NORMALIZER

    def chunked(t, d):
        return t.astype(jnp.float32).reshape(bsz, n_chunks, CHUNK, GLA_HEADS, d)

    q = chunked(q, HEAD_K) * (HEAD_K ** -0.5)
    k = chunked(k, HEAD_K)
    v = chunked(v, HEAD_V)
    log_a = chunked(log_a, HEAD_K)
    cum = jnp.cumsum(log_a, axis=2)
    tot = cum[:, :, -1]
    k_dec = k * jnp.exp(tot[:, :, None] - cum)
    upd = jnp.einsum('bnlhk,bnlhv->nbhkv', k_dec, v)
    q_n = jnp.moveaxis(q, 1, 0)
    decay = jnp.moveaxis(jnp.exp(tot), 1, 0)

    def step(state, inp):
        q_c, d_c, u_c = inp
        state = d_c[..., None] * state + u_c
        return state, jnp.einsum('blhk,bhkv->blhv', q_c, state)

    s0 = jnp.zeros((bsz, GLA_HEADS, HEAD_K, HEAD_V), jnp.float32)
    _, o = lax.scan(step, s0, (q_n, decay, upd))
    o = jnp.moveaxis(o, 0, 1).reshape(bsz, seq, GLA_HEADS, HEAD_V)
    o = o * lax.rsqrt(jnp.mean(o * o, axis=-1, keepdims=True) + RMS_EPS)
    o = o.reshape(bsz, seq, VALUE_DIM) * gn.astype(jnp.float32) * jax.nn.silu(r.astype(jnp.float32))
    return o.astype(x.dtype) @ w_out


def _short_conv_mixer(x, w_in, conv_w, w_out):
    b_gate, c_gate, h = jnp.split(x @ w_in, 3, axis=-1)
    return (b_gate * _causal_dwconv(c_gate * h, conv_w)) @ w_out


def _conv_ffn(x, w_up, conv_w, w_down):
    g, u = jnp.split(x @ w_up, 2, axis=-1)
    return (jax.nn.silu(_causal_dwconv(g, conv_w)) * u) @ w_down


def setup_inputs(seed: int = 0) -> dict:
    key = jax.random.key(seed)
    ks = jax.random.split(key, 20)
    nrm = jax.random.normal
    f32 = jnp.float32
    d = D_MODEL
    return {
        'x': nrm(ks[0], (BATCH, SEQ, d), f32),
        'a_norm': 1.0 + 0.05 * nrm(ks[1], (N_LAYERS_A, d), f32),
        'a_w_in': nrm(ks[2], (N_LAYERS_A, d, PROJ_A), f32) * d ** -0.5,
        'a_w_gate_up': nrm(ks[3], (N_LAYERS_A, GATE_RANK, KEY_DIM), f32) * GATE_RANK ** -0.5,
        'a_b_gate': 0.1 * nrm(ks[4], (N_LAYERS_A, KEY_DIM), f32),
        'a_gn': 1.0 + 0.05 * nrm(ks[5], (N_LAYERS_A, VALUE_DIM), f32),
        'a_w_out': nrm(ks[6], (N_LAYERS_A, VALUE_DIM, d), f32) * VALUE_DIM ** -0.5,
        'b_norm': 1.0 + 0.05 * nrm(ks[7], (N_LAYERS_B, d), f32),
        'b_w_in': nrm(ks[8], (N_LAYERS_B, d, 3 * CONV_DIM), f32) * d ** -0.5,
        'b_conv': nrm(ks[9], (N_LAYERS_B, CONV_WIDTH, CONV_DIM), f32) * CONV_WIDTH ** -0.5,
        'b_w_out': nrm(ks[10], (N_LAYERS_B, CONV_DIM, d), f32) * CONV_DIM ** -0.5,
        'f_norm': 1.0 + 0.05 * nrm(ks[11], (DEPTH, d), f32),
        'f_w_up': nrm(ks[12], (DEPTH, d, 2 * D_FF), f32) * d ** -0.5,
        'f_conv': nrm(ks[13], (DEPTH, FFN_CONV_WIDTH, D_FF), f32) * FFN_CONV_WIDTH ** -0.5,
        'f_w_down': nrm(ks[14], (DEPTH, D_FF, d), f32) * D_FF ** -0.5,
        'final_norm': 1.0 + 0.05 * nrm(ks[15], (d,), f32),
    }


def reference(x, a_norm, a_w_in, a_w_gate_up, a_b_gate, a_gn, a_w_out,
              b_norm, b_w_in, b_conv, b_w_out,
              f_norm, f_w_up, f_conv, f_w_down, final_norm):
    for i in range(DEPTH):
        j = i // N_MIXERS
        if i % N_MIXERS == 0:
            h = _rmsnorm(x, a_norm[j])
            x = x + _gla_mixer(h, a_w_in[j], a_w_gate_up[j], a_b_gate[j], a_gn[j], a_w_out[j])
        else:
            h = _rmsnorm(x, b_norm[j])
            x = x + _short_conv_mixer(h, b_w_in[j], b_conv[j], b_w_out[j])
        h = _rmsnorm(x, f_norm[i])
        x = x + _conv_ffn(h, f_w_up[i], f_conv[i], f_w_down[i])
    return _rmsnorm(x, final_norm)
```

```cpp
#include <hip/hip_runtime.h>
#include <cstdint>
#include <cstdio>

namespace {
constexpr int D = 1024, BATCH = 8, SEQ = 2048, CHUNK = 64, NCH = SEQ / CHUNK;
constexpr int KEY = 512, VAL = 1024, HK = 128, HV = 256, NH = 4, GR = 16;
constexpr int PROJ_A = 2 * KEY + 2 * VAL + GR;
constexpr int DFF = 2816;
constexpr float EPS = 1e-6f;

__device__ __forceinline__ float wave_sum(float v) {
#pragma unroll
    for (int o = 1; o < 64; o <<= 1) v += __shfl_xor(v, o);
    return v;
}
__device__ __forceinline__ float silu_f(float x) { return x / (1.f + expf(-x)); }
__device__ __forceinline__ float logsig_f(float x) { return fminf(x, 0.f) - log1pf(expf(-fabsf(x))); }

__global__ void rmsnorm_k(const float* __restrict__ x, const float* __restrict__ g, float* __restrict__ out, int rows) {
    const int w = (blockIdx.x * blockDim.x + threadIdx.x) >> 6, lane = threadIdx.x & 63;
    if (w >= rows) return;
    const float* xr = x + (size_t)w * D;
    float v[16], s = 0.f;
#pragma unroll
    for (int j = 0; j < 16; ++j) { v[j] = xr[lane + 64 * j]; s += v[j] * v[j]; }
    const float r = rsqrtf(wave_sum(s) * (1.f / D) + EPS);
#pragma unroll
    for (int j = 0; j < 16; ++j) out[(size_t)w * D + lane + 64 * j] = v[j] * r * g[lane + 64 * j];
}

__global__ void __launch_bounds__(256) gemm_k(const float* __restrict__ A, int lda, const float* __restrict__ W, int N, int K,
                                              float* __restrict__ C, int ldc, const float* __restrict__ R) {
    __shared__ float As[16][64 + 4];
    __shared__ float Bs[16][64 + 4];
    const int tid = threadIdx.x, tx = tid & 15, ty = tid >> 4;
    const int m0 = blockIdx.y * 64, n0 = blockIdx.x * 64;
    float acc[4][4] = {};
    for (int k0 = 0; k0 < K; k0 += 16) {
        {
            const int r = tid >> 2, kk = (tid & 3) * 4;
            const float4 a = *(const float4*)(A + (size_t)(m0 + r) * lda + k0 + kk);
            As[kk + 0][r] = a.x; As[kk + 1][r] = a.y; As[kk + 2][r] = a.z; As[kk + 3][r] = a.w;
            const int kr = tid >> 4, nc = (tid & 15) * 4;
#pragma unroll
            for (int j = 0; j < 4; ++j) { const int n = n0 + nc + j; Bs[kr][nc + j] = n < N ? W[(size_t)(k0 + kr) * N + n] : 0.f; }
        }
        __syncthreads();
#pragma unroll
        for (int kk = 0; kk < 16; ++kk) {
            float a[4], b[4];
#pragma unroll
            for (int i = 0; i < 4; ++i) { a[i] = As[kk][ty * 4 + i]; b[i] = Bs[kk][tx * 4 + i]; }
#pragma unroll
            for (int i = 0; i < 4; ++i)
#pragma unroll
                for (int j = 0; j < 4; ++j) acc[i][j] += a[i] * b[j];
        }
        __syncthreads();
    }
#pragma unroll
    for (int i = 0; i < 4; ++i)
#pragma unroll
        for (int j = 0; j < 4; ++j) {
            const int m = m0 + ty * 4 + i, n = n0 + tx * 4 + j;
            if (n < N) { float v = acc[i][j]; if (R) v += R[(size_t)m * ldc + n]; C[(size_t)m * ldc + n] = v; }
        }
}

__global__ void gla_gate_k(const float* __restrict__ proj, const float* __restrict__ Wg, const float* __restrict__ bg, float* __restrict__ loga) {
    const int idx = blockIdx.x * blockDim.x + threadIdx.x;
    const int t = idx >> 9, c = idx & 511;
    const float* gl = proj + (size_t)t * PROJ_A + 3072;
    float s = bg[c];
#pragma unroll
    for (int j = 0; j < GR; ++j) s += gl[j] * Wg[j * KEY + c];
    loga[idx] = logsig_f(s) * (1.f / 16.f);
}
__global__ void gla_cum_k(const float* __restrict__ proj, const float* __restrict__ loga, float* __restrict__ kdec, float* __restrict__ decay) {
    const int idx = blockIdx.x * blockDim.x + threadIdx.x;
    const int n = idx >> 9, c = idx & 511;
    float s = 0.f, cum = 0.f;
    for (int l = 0; l < CHUNK; ++l) s += loga[(size_t)(n * CHUNK + l) * KEY + c];
    for (int l = 0; l < CHUNK; ++l) { const size_t t = (size_t)(n * CHUNK + l); cum += loga[t * KEY + c]; kdec[t * KEY + c] = proj[t * PROJ_A + KEY + c] * expf(s - cum); }
    decay[idx] = expf(s);
}
__global__ void gla_scan_k(const float* __restrict__ proj, const float* __restrict__ kdec, const float* __restrict__ decay, float* __restrict__ S) {
    const int idx = blockIdx.x * blockDim.x + threadIdx.x;
    const int v = idx & 255, k = (idx >> 8) & 127, h = idx >> 15;
    float st = 0.f;
    for (int n = 0; n < NCH; ++n) {
        float u = 0.f;
        for (int l = 0; l < CHUNK; ++l) { const size_t t = (size_t)(n * CHUNK + l); u += kdec[t * KEY + h * HK + k] * proj[t * PROJ_A + 2 * KEY + h * HV + v]; }
        st = decay[n * KEY + h * HK + k] * st + u;
        S[(size_t)n * (NH * HK * HV) + idx] = st;
    }
}
__global__ void gla_out_k(const float* __restrict__ proj, const float* __restrict__ S, float* __restrict__ o) {
    const int idx = blockIdx.x * blockDim.x + threadIdx.x;
    const int t = idx >> 10, hv = idx & 1023, h = hv >> 8, v = hv & 255, n = t / CHUNK;
    const float* q = proj + (size_t)t * PROJ_A + h * HK;
    const float* s = S + (size_t)n * (NH * HK * HV) + (size_t)h * HK * HV + v;
    float acc = 0.f;
    for (int k = 0; k < HK; ++k) acc += q[k] * s[(size_t)k * HV];
    o[idx] = acc * 0.08838834764831845f;
}
__global__ void gla_normgate_k(const float* __restrict__ o, const float* __restrict__ proj, const float* __restrict__ gn, float* __restrict__ y) {
    const int w = (blockIdx.x * blockDim.x + threadIdx.x) >> 6, lane = threadIdx.x & 63;
    const int t = w >> 2, h = w & 3;
    const float* orow = o + (size_t)t * VAL + h * HV;
    float v[4], s = 0.f;
#pragma unroll
    for (int j = 0; j < 4; ++j) { v[j] = orow[lane + 64 * j]; s += v[j] * v[j]; }
    const float r = rsqrtf(wave_sum(s) * (1.f / HV) + EPS);
#pragma unroll
    for (int j = 0; j < 4; ++j) { const int c = h * HV + lane + 64 * j; y[(size_t)t * VAL + c] = v[j] * r * gn[c] * silu_f(proj[(size_t)t * PROJ_A + 2 * KEY + VAL + c]); }
}
__global__ void sconv_k(const float* __restrict__ p, const float* __restrict__ cw, float* __restrict__ y) {
    const int idx = blockIdx.x * blockDim.x + threadIdx.x;
    const int t = idx >> 10, c = idx & 1023;
    float acc = 0.f;
#pragma unroll
    for (int j = 0; j < 3; ++j) { const int tt = t - 2 + j; if (tt >= 0) acc += cw[j * D + c] * p[(size_t)tt * 3072 + 1024 + c] * p[(size_t)tt * 3072 + 2048 + c]; }
    y[idx] = p[(size_t)t * 3072 + c] * acc;
}
__global__ void ffnconv_k(const float* __restrict__ gu, const float* __restrict__ cw, float* __restrict__ z) {
    const int idx = blockIdx.x * blockDim.x + threadIdx.x;
    const int t = idx / DFF, c = idx % DFF;
    float acc = 0.f;
#pragma unroll
    for (int j = 0; j < 3; ++j) { const int tt = t - 2 + j; if (tt >= 0) acc += cw[j * DFF + c] * gu[(size_t)tt * (2 * DFF) + c]; }
    z[idx] = silu_f(acc) * gu[(size_t)t * (2 * DFF) + DFF + c];
}
}

static void gemm(hipStream_t st, const float* A, int lda, const float* W, int M, int N, int K, float* C, int ldc, const float* R) {
    dim3 g((N + 63) / 64, M / 64);
    hipLaunchKernelGGL(gemm_k, g, dim3(256), 0, st, A, lda, W, N, K, C, ldc, R);
}

extern "C" void kernel_launch(void* const* d_in, const int* in_sizes, int n_in, void* d_out, int out_size, void* d_ws, size_t ws_size, hipStream_t stream) {
    const float* x = (const float*)d_in[0];
    const float* a_norm = (const float*)d_in[1]; const float* a_w_in = (const float*)d_in[2]; const float* a_wg = (const float*)d_in[3];
    const float* a_bg = (const float*)d_in[4]; const float* a_gn = (const float*)d_in[5]; const float* a_w_out = (const float*)d_in[6];
    const float* b_norm = (const float*)d_in[7]; const float* b_w_in = (const float*)d_in[8]; const float* b_conv = (const float*)d_in[9];
    const float* b_w_out = (const float*)d_in[10]; const float* f_norm = (const float*)d_in[11]; const float* f_w_up = (const float*)d_in[12];
    const float* f_conv = (const float*)d_in[13]; const float* f_w_down = (const float*)d_in[14]; const float* final_norm = (const float*)d_in[15];
    float* out = (float*)d_out;
    float* ws = (float*)d_ws;
    const int T = SEQ;
    float* h = ws;
    float* big = h + (size_t)T * D;
    float* t1 = big + (size_t)T * 2 * DFF;
    float* x1 = t1 + (size_t)T * DFF;
    float* x2 = x1 + (size_t)T * D;
    float* loga = x2 + (size_t)T * D;
    float* kdec = loga + (size_t)T * KEY;
    float* decay = kdec + (size_t)T * KEY;
    float* S = decay + NCH * KEY;
    float* o = S + (size_t)NCH * NH * HK * HV;
    for (int b = 0; b < BATCH; ++b) {
        const float* xb = x + (size_t)b * T * D;
        float* ob = out + (size_t)b * T * D;
        hipLaunchKernelGGL(rmsnorm_k, dim3(T / 4), dim3(256), 0, stream, xb, a_norm, h, T);
        gemm(stream, h, D, a_w_in, T, PROJ_A, D, big, PROJ_A, nullptr);
        hipLaunchKernelGGL(gla_gate_k, dim3(T * KEY / 256), dim3(256), 0, stream, big, a_wg, a_bg, loga);
        hipLaunchKernelGGL(gla_cum_k, dim3(NCH * KEY / 256), dim3(256), 0, stream, big, loga, kdec, decay);
        hipLaunchKernelGGL(gla_scan_k, dim3(NH * HK * HV / 256), dim3(256), 0, stream, big, kdec, decay, S);
        hipLaunchKernelGGL(gla_out_k, dim3(T * VAL / 256), dim3(256), 0, stream, big, S, o);
        hipLaunchKernelGGL(gla_normgate_k, dim3(T * NH / 4), dim3(256), 0, stream, o, big, a_gn, t1);
        gemm(stream, t1, VAL, a_w_out, T, D, VAL, x1, D, xb);
        hipLaunchKernelGGL(rmsnorm_k, dim3(T / 4), dim3(256), 0, stream, x1, f_norm, h, T);
        gemm(stream, h, D, f_w_up, T, 2 * DFF, D, big, 2 * DFF, nullptr);
        hipLaunchKernelGGL(ffnconv_k, dim3(T * DFF / 256), dim3(256), 0, stream, big, f_conv, t1);
        gemm(stream, t1, DFF, f_w_down, T, D, DFF, x2, D, x1);
        hipLaunchKernelGGL(rmsnorm_k, dim3(T / 4), dim3(256), 0, stream, x2, b_norm, h, T);
        gemm(stream, h, D, b_w_in, T, 3 * D, D, big, 3 * D, nullptr);
        hipLaunchKernelGGL(sconv_k, dim3(T * D / 256), dim3(256), 0, stream, big, b_conv, t1);
        gemm(stream, t1, D, b_w_out, T, D, D, x1, D, x2);
        hipLaunchKernelGGL(rmsnorm_k, dim3(T / 4), dim3(256), 0, stream, x1, f_norm + D, h, T);
        gemm(stream, h, D, f_w_up + (size_t)D * 2 * DFF, T, 2 * DFF, D, big, 2 * DFF, nullptr);
        hipLaunchKernelGGL(ffnconv_k, dim3(T * DFF / 256), dim3(256), 0, stream, big, f_conv + 3 * DFF, t1);
        gemm(stream, t1, DFF, f_w_down + (size_t)DFF * D, T, D, DFF, x2, D, x1);
        hipLaunchKernelGGL(rmsnorm_k, dim3(T / 4), dim3(256), 0, stream, x2, final_norm, ob, T);
    }
}
```
